# Optimizing an MI355X kernel written in HIP

```python
import jax, jax.numpy as jnp
from jax import lax
import numpy as np

D_MODEL = 1024
BATCH = 2
SEQ = 8192
DEPTH = 2

N_MEM = 256
N_EVEN = (DEPTH + 1) // 2
N_ODD = DEPTH // 2
ALPHA = (2.0 * DEPTH) ** 0.25
BETA = (8.0 * DEPTH) ** -0.25
LN_EPS = 1e-5
NEG = -1e30
POOL_WIDTH = D_MODEL // 2
POOL_WINDOWS = (2, 4, 8, 16)
POOL_GROUP = POOL_WIDTH // len(POOL_WINDOWS)
NSA_HEADS = 8
NSA_KV_HEADS = 2
NSA_HEAD_DIM = (D_MODEL // 2) // NSA_HEADS
NSA_GROUP = NSA_HEADS // NSA_KV_HEADS
CMP_BLOCK = 32
CMP_STRIDE = 16
SEL_BLOCK = 64
SEL_COUNT = 16
WINDOW = 512
Q_BLOCK = 128
N_BRANCH = 3
FORCE_SCORE = 1e4
ROPE_THETA = 500000.0
ROT_DIM = NSA_HEAD_DIM // 4
Q_WIDTH = NSA_HEADS * NSA_HEAD_DIM
KV_WIDTH = NSA_KV_HEADS * NSA_HEAD_DIM
GATE_WIDTH = NSA_HEADS * N_BRANCH
EVEN_SPLITS = (POOL_WIDTH, Q_WIDTH, GATE_WIDTH) + (KV_WIDTH,) * (2 * N_BRANCH)
EVEN_IN_WIDTH = sum(EVEN_SPLITS)
RNN_WIDTH = 1280
RNN_BLOCKS = 10
RNN_BLOCK_W = RNN_WIDTH // RNN_BLOCKS
CONV_WIDTH = 4
LRU_C = 8.0
X_HEADS = 4
X_HEAD_DIM = D_MODEL // X_HEADS
FFN_HIDDEN = ((8 * D_MODEL // 3 + 255) // 256) * 256

kernel_name = "hybrid_pool_nsa_rglru_deepnorm"


def layer_norm(x, g, b):
    xf = x.astype(jnp.float32)
    mu = jnp.mean(xf, axis=-1, keepdims=True)
    var = jnp.mean(jnp.square(xf - mu), axis=-1, keepdims=True)
    y = (xf - mu) * lax.rsqrt(var + LN_EPS)
    return (y * g.astype(jnp.float32) + b.astype(jnp.float32)).astype(x.dtype)


def rotary(x, pos):
    half = ROT_DIM // 2
    inv = ROPE_THETA ** (-jnp.arange(half, dtype=jnp.float32) * 2.0 / ROT_DIM)
    ang = pos.astype(jnp.float32)[..., None] * inv
    cos = jnp.cos(ang)[:, :, None, :].astype(x.dtype)
    sin = jnp.sin(ang)[:, :, None, :].astype(x.dtype)
    x1 = x[..., :half]
    x2 = x[..., half:ROT_DIM]
    return jnp.concatenate([x1 * cos - x2 * sin, x2 * cos + x1 * sin, x[..., ROT_DIM:]], axis=-1)


def masked_softmax(s, valid):
    p = jax.nn.softmax(jnp.where(valid, s, NEG), axis=-1)
    return p * valid.astype(p.dtype)


def multiscale_pool(u, w_pool, scale):
    B, S, C = u.shape
    uf = u.astype(jnp.float32)
    csum = jnp.pad(jnp.cumsum(uf, axis=1), ((0, 0), (1, 0), (0, 0)))
    t = jnp.arange(S)
    outs = []
    for g, w in enumerate(POOL_WINDOWS):
        sl = slice(g * POOL_GROUP, (g + 1) * POOL_GROUP)
        cg = csum[..., sl]
        lo = jnp.maximum(t + 1 - w, 0)
        total = cg[:, 1:] - jnp.take(cg, lo, axis=1)
        count = jnp.minimum(t + 1, w).astype(jnp.float32)[None, :, None]
        outs.append(total / count - uf[..., sl])
    pooled = jnp.stack(outs, axis=2).astype(u.dtype)
    mixed = jnp.einsum('bsgc,gcd->bsgd', pooled, w_pool)
    return mixed.reshape(B, S, C) * scale


def nsa_attention(q, gates, k_cmp, v_cmp, k_sel, v_sel, k_win, v_win, positions,
                  cmp_pos_k, cmp_pos_v, cmp_wk, cmp_wv):
    B, S = q.shape[:2]
    G, R, HD = NSA_KV_HEADS, NSA_GROUP, NSA_HEAD_DIM
    scale = HD ** -0.5
    q = rotary(q, positions)
    k_sel = rotary(k_sel, positions)
    k_win = rotary(k_win, positions)

    n_cmp = (S - CMP_BLOCK) // CMP_STRIDE + 1
    starts = jnp.arange(n_cmp) * CMP_STRIDE
    cmp_end = starts + CMP_BLOCK - 1
    idx = starts[:, None] + jnp.arange(CMP_BLOCK)[None, :]

    def compress(raw, pos_emb, w):
        blocks = raw[:, idx] + pos_emb[None, None, :, None, :]
        blocks = blocks.transpose(0, 1, 3, 2, 4).reshape(B, n_cmp, G, CMP_BLOCK * HD)
        return blocks @ w

    kc = rotary(compress(k_cmp, cmp_pos_k, cmp_wk), positions[:, cmp_end])
    vc = compress(v_cmp, cmp_pos_v, cmp_wv)

    n_sb = S // SEL_BLOCK
    n_pick = min(SEL_COUNT, n_sb)
    jb = jnp.arange(n_sb)
    overlap = ((starts[:, None] < (jb[None, :] + 1) * SEL_BLOCK)
               & (starts[:, None] + CMP_BLOCK > jb[None, :] * SEL_BLOCK)).astype(jnp.float32)
    ks_blk = k_sel.reshape(B, n_sb, SEL_BLOCK, G, HD).transpose(0, 3, 1, 2, 4)
    vs_blk = v_sel.reshape(B, n_sb, SEL_BLOCK, G, HD).transpose(0, 3, 1, 2, 4)
    b_ix = jnp.arange(B)[:, None, None, None]
    g_ix = jnp.arange(G)[None, :, None, None]

    kw_pad = jnp.pad(k_win, ((0, 0), (WINDOW, 0), (0, 0), (0, 0)))
    vw_pad = jnp.pad(v_win, ((0, 0), (WINDOW, 0), (0, 0), (0, 0)))

    n_qb = S // Q_BLOCK
    q_blocks = q.reshape(B, n_qb, Q_BLOCK, G, R, HD).transpose(1, 0, 2, 3, 4, 5)
    g_blocks = gates.reshape(B, n_qb, Q_BLOCK, G, R, N_BRANCH).transpose(1, 0, 2, 3, 4, 5)

    def one_block(args):
        qb_i, qb, gb = args
        q0 = qb_i * Q_BLOCK
        t = q0 + jnp.arange(Q_BLOCK)
        s = jnp.einsum('bqgrd,bngd->bgrqn', qb, kc).astype(jnp.float32) * scale
        p_c = masked_softmax(s, cmp_end[None, :] <= t[:, None])
        o_c = jnp.einsum('bgrqn,bngd->bqgrd', p_c.astype(qb.dtype), vc)
        imp = jnp.einsum('bgrqn,nj->bgqj', p_c, overlap)
        cur = t // SEL_BLOCK
        forced = (jb[None, :] == 0) | (jb[None, :] == cur[:, None]) | (jb[None, :] == cur[:, None] - 1)
        future = jb[None, :] > cur[:, None]
        imp = jnp.where(forced, FORCE_SCORE, jnp.where(future, -1.0, imp))
        _, sel = lax.top_k(imp, n_pick)
        k_g = ks_blk[b_ix, g_ix, sel]
        v_g = vs_blk[b_ix, g_ix, sel]
        kpos = sel[..., None] * SEL_BLOCK + jnp.arange(SEL_BLOCK)
        s = jnp.einsum('bqgrd,bgqnld->bgrqnl', qb, k_g).astype(jnp.float32) * scale
        valid = (kpos <= t[:, None, None])[:, :, None]
        m = n_pick * SEL_BLOCK
        p_s = masked_softmax(s.reshape(B, G, R, Q_BLOCK, m), valid.reshape(B, G, 1, Q_BLOCK, m))
        o_s = jnp.einsum('bgrqm,bgqmd->bqgrd', p_s.astype(qb.dtype), v_g.reshape(B, G, Q_BLOCK, m, HD))
        kwb = lax.dynamic_slice_in_dim(kw_pad, q0, WINDOW + Q_BLOCK, axis=1)
        vwb = lax.dynamic_slice_in_dim(vw_pad, q0, WINDOW + Q_BLOCK, axis=1)
        kpw = q0 - WINDOW + jnp.arange(WINDOW + Q_BLOCK)
        valid_w = ((kpw[None, :] <= t[:, None]) & (kpw[None, :] > t[:, None] - WINDOW)
                   & (kpw[None, :] >= 0))
        s = jnp.einsum('bqgrd,bkgd->bgrqk', qb, kwb).astype(jnp.float32) * scale
        p_w = masked_softmax(s, valid_w)
        o_w = jnp.einsum('bgrqk,bkgd->bqgrd', p_w.astype(qb.dtype), vwb)
        return gb[..., 0:1] * o_c + gb[..., 1:2] * o_s + gb[..., 2:3] * o_w

    out = lax.map(one_block, (jnp.arange(n_qb), q_blocks, g_blocks))
    return out.transpose(1, 0, 2, 3, 4, 5).reshape(B, S, NSA_HEADS * HD)


def pool_nsa_mixer(x, positions, w_in, pool_w, pool_scale, cmp_pos_k, cmp_pos_v,
                   cmp_wk, cmp_wv, w_out):
    B, S, _ = x.shape
    u = x @ w_in
    cuts = [int(c) for c in np.cumsum(EVEN_SPLITS)[:-1]]
    pool_in, q, gate_logits, kc, vc, ks, vs, kw, vw = jnp.split(u, cuts, axis=-1)
    kv = lambda a: a.reshape(B, S, NSA_KV_HEADS, NSA_HEAD_DIM)
    q = q.reshape(B, S, NSA_HEADS, NSA_HEAD_DIM)
    gates = jax.nn.sigmoid(gate_logits).reshape(B, S, NSA_HEADS, N_BRANCH)
    pool_out = multiscale_pool(pool_in, pool_w, pool_scale)
    nsa_out = nsa_attention(q, gates, kv(kc), kv(vc), kv(ks), kv(vs), kv(kw), kv(vw), positions,
                            cmp_pos_k, cmp_pos_v, cmp_wk, cmp_wv)
    return jnp.concatenate([pool_out, nsa_out], axis=-1) @ w_out


def rglru_mixer(x, positions, w_in, conv_w, conv_b, wa, ba, wx, bx, lam, w_out):
    B, S, _ = x.shape
    u = x @ w_in
    gate, xr = u[..., :RNN_WIDTH], u[..., RNN_WIDTH:]
    xp = jnp.pad(xr, ((0, 0), (CONV_WIDTH - 1, 0), (0, 0)))
    xc = conv_b
    for k in range(CONV_WIDTH):
        xc = xc + xp[:, k:k + S] * conv_w[k]
    xb = xc.reshape(B, S, RNN_BLOCKS, RNN_BLOCK_W)
    r = jax.nn.sigmoid(jnp.einsum('bshi,hij->bshj', xb, wa).reshape(B, S, RNN_WIDTH) + ba)
    i = jax.nn.sigmoid(jnp.einsum('bshi,hij->bshj', xb, wx).reshape(B, S, RNN_WIDTH) + bx)
    log_a = -LRU_C * r.astype(jnp.float32) * jax.nn.softplus(-lam.astype(jnp.float32))
    a = jnp.exp(log_a)
    mult = jnp.sqrt(-jnp.expm1(2.0 * log_a))
    reset = (positions == 0)[..., None]
    a = jnp.where(reset, 0.0, a)
    mult = jnp.where(reset, 1.0, mult)
    b = mult * (i * xc).astype(jnp.float32)

    def combine(left, right):
        a1, b1 = left
        a2, b2 = right
        return a1 * a2, a2 * b1 + b2

    _, h = lax.associative_scan(combine, (a, b), axis=1)
    y = h.astype(x.dtype) * jax.nn.gelu(gate)
    return y @ w_out


def memory_cross_attention(x, mem, wq, wkv, wo):
    B, S, D = x.shape
    M = mem.shape[1]
    q = (x @ wq).reshape(B, S, X_HEADS, X_HEAD_DIM)
    kv = mem @ wkv
    k = kv[..., :D].reshape(B, M, X_HEADS, X_HEAD_DIM)
    v = kv[..., D:].reshape(B, M, X_HEADS, X_HEAD_DIM)
    s = jnp.einsum('bshd,bmhd->bhsm', q, k).astype(jnp.float32) * (X_HEAD_DIM ** -0.5)
    p = jax.nn.softmax(s, axis=-1).astype(x.dtype)
    o = jnp.einsum('bhsm,bmhd->bshd', p, v).reshape(B, S, D)
    return o @ wo


def swiglu(x, w_up, w_down):
    h = x @ w_up
    return (jax.nn.silu(h[..., :FFN_HIDDEN]) * h[..., FFN_HIDDEN:]) @ w_down


def setup_inputs(seed: int = 0) -> dict:
    key = jax.random.key(seed)
    ks = iter(jax.random.split(key, 40))
    nrm = lambda shape: jax.random.normal(next(ks), shape, jnp.float32)
    dense = lambda shape, fan_in, gain=1.0: nrm(shape) * (fan_in ** -0.5) * gain
    D, HD = D_MODEL, NSA_HEAD_DIM
    u = jax.random.uniform(next(ks), (N_ODD, RNN_WIDTH), jnp.float32, 0.9, 0.999)
    s = u ** (1.0 / LRU_C)
    return {
        "x": nrm((BATCH, SEQ, D)),
        "mem": nrm((BATCH, N_MEM, D)),
        "positions": jnp.broadcast_to(jnp.arange(SEQ, dtype=jnp.int32), (BATCH, SEQ)),
        "e_w_in": dense((N_EVEN, D, EVEN_IN_WIDTH), D),
        "e_pool_w": dense((N_EVEN, len(POOL_WINDOWS), POOL_GROUP, POOL_GROUP), POOL_GROUP),
        "e_pool_scale": 1.0 + 0.02 * nrm((N_EVEN, POOL_WIDTH)),
        "e_cmp_pos_k": 0.1 * nrm((N_EVEN, CMP_BLOCK, HD)),
        "e_cmp_pos_v": 0.1 * nrm((N_EVEN, CMP_BLOCK, HD)),
        "e_cmp_wk": dense((N_EVEN, CMP_BLOCK * HD, HD), CMP_BLOCK * HD),
        "e_cmp_wv": dense((N_EVEN, CMP_BLOCK * HD, HD), CMP_BLOCK * HD),
        "e_w_out": dense((N_EVEN, D, D), D, BETA),
        "o_w_in": dense((N_ODD, D, 2 * RNN_WIDTH), D),
        "o_conv_w": dense((N_ODD, CONV_WIDTH, RNN_WIDTH), CONV_WIDTH),
        "o_conv_b": 0.01 * nrm((N_ODD, RNN_WIDTH)),
        "o_wa": dense((N_ODD, RNN_BLOCKS, RNN_BLOCK_W, RNN_BLOCK_W), RNN_BLOCK_W),
        "o_ba": 0.01 * nrm((N_ODD, RNN_WIDTH)),
        "o_wx": dense((N_ODD, RNN_BLOCKS, RNN_BLOCK_W, RNN_BLOCK_W), RNN_BLOCK_W),
        "o_bx": 0.01 * nrm((N_ODD, RNN_WIDTH)),
        "o_lambda": jnp.log(s) - jnp.log1p(-s),
        "o_w_out": dense((N_ODD, RNN_WIDTH, D), RNN_WIDTH, BETA),
        "x_wq": dense((DEPTH, D, D), D),
        "x_wkv": dense((DEPTH, D, 2 * D), D),
        "x_wo": dense((DEPTH, D, D), D, BETA),
        "f_w_up": dense((DEPTH, D, 2 * FFN_HIDDEN), D),
        "f_w_down": dense((DEPTH, FFN_HIDDEN, D), FFN_HIDDEN, BETA),
        "ln_g": 1.0 + 0.02 * nrm((DEPTH, 3, D)),
        "ln_b": 0.01 * nrm((DEPTH, 3, D)),
    }


def reference(x, mem, positions, e_w_in, e_pool_w, e_pool_scale, e_cmp_pos_k, e_cmp_pos_v,
              e_cmp_wk, e_cmp_wv, e_w_out, o_w_in, o_conv_w, o_conv_b, o_wa, o_ba, o_wx, o_bx,
              o_lambda, o_w_out, x_wq, x_wkv, x_wo, f_w_up, f_w_down, ln_g, ln_b):
    for layer in range(DEPTH):
        j = layer // 2
        if layer % 2 == 0:
            m = pool_nsa_mixer(x, positions, e_w_in[j], e_pool_w[j], e_pool_scale[j],
                               e_cmp_pos_k[j], e_cmp_pos_v[j], e_cmp_wk[j], e_cmp_wv[j], e_w_out[j])
        else:
            m = rglru_mixer(x, positions, o_w_in[j], o_conv_w[j], o_conv_b[j], o_wa[j], o_ba[j],
                            o_wx[j], o_bx[j], o_lambda[j], o_w_out[j])
        x = layer_norm(ALPHA * x + m, ln_g[layer, 0], ln_b[layer, 0])
        c = memory_cross_attention(x, mem, x_wq[layer], x_wkv[layer], x_wo[layer])
        x = layer_norm(ALPHA * x + c, ln_g[layer, 1], ln_b[layer, 1])
        f = swiglu(x, f_w_up[layer], f_w_down[layer])
        x = layer_norm(ALPHA * x + f, ln_g[layer, 2], ln_b[layer, 2])
    return x
```

```cpp
#include <hip/hip_runtime.h>
#include <cstdio>
#include <cstdint>
#include <cmath>

namespace nv {
constexpr int B = 2, S = 8192, D = 1024, M = B * S;
constexpr int NMEM = 256;
constexpr float ALPHA = 1.41421356237f;
constexpr float LN_EPS = 1e-5f;
constexpr int EW = 1816;
constexpr int C_POOL = 0, C_Q = 512, C_GATE = 1024, C_KC = 1048, C_VC = 1176, C_KS = 1304, C_VS = 1432, C_KW = 1560, C_VW = 1688;
constexpr int NC = 511;
constexpr int RNN = 1280;
constexpr int FF = 2816;

__global__ void __launch_bounds__(256) k_gemm(const float* __restrict__ A, int lda, const float* __restrict__ W, int ldw, float* __restrict__ C, int ldc,
                                              int Mr, int N, int K, const float* __restrict__ colscale) {
    __shared__ float As[16][65];
    __shared__ float Ws[16][65];
    const int tx = threadIdx.x & 15, ty = threadIdx.x >> 4;
    const int m0 = blockIdx.y * 64, n0 = blockIdx.x * 64;
    float acc[4][4] = {};
    for (int k0 = 0; k0 < K; k0 += 16) {
        for (int i = threadIdx.x; i < 64 * 16; i += 256) {
            const int r = i >> 4, c = i & 15;
            As[c][r] = (m0 + r < Mr && k0 + c < K) ? A[(size_t)(m0 + r) * lda + k0 + c] : 0.f;
        }
        for (int i = threadIdx.x; i < 16 * 64; i += 256) {
            const int r = i >> 6, c = i & 63;
            Ws[r][c] = (k0 + r < K && n0 + c < N) ? W[(size_t)(k0 + r) * ldw + n0 + c] : 0.f;
        }
        __syncthreads();
#pragma unroll
        for (int k = 0; k < 16; ++k) {
            float a[4], w[4];
#pragma unroll
            for (int i = 0; i < 4; ++i) { a[i] = As[k][ty * 4 + i]; w[i] = Ws[k][tx * 4 + i]; }
#pragma unroll
            for (int i = 0; i < 4; ++i)
#pragma unroll
                for (int j = 0; j < 4; ++j) acc[i][j] += a[i] * w[j];
        }
        __syncthreads();
    }
    for (int i = 0; i < 4; ++i)
        for (int j = 0; j < 4; ++j) {
            const int m = m0 + ty * 4 + i, n = n0 + tx * 4 + j;
            if (m < Mr && n < N) C[(size_t)m * ldc + n] = acc[i][j] * (colscale ? colscale[n] : 1.f);
        }
}

__global__ void __launch_bounds__(256) k_ln(const float* __restrict__ x, const float* m, const float* __restrict__ g, const float* __restrict__ b, float* out) {
    __shared__ float red[8];
    const int row = blockIdx.x, t = threadIdx.x;
    float v[4]; float s = 0.f;
    for (int i = 0; i < 4; ++i) { const int c = t + 256 * i; v[i] = ALPHA * x[(size_t)row * D + c] + m[(size_t)row * D + c]; s += v[i]; }
    for (int o = 32; o > 0; o >>= 1) s += __shfl_xor(s, o);
    if ((t & 63) == 0) red[t >> 6] = s;
    __syncthreads();
    const float mean = (red[0] + red[1] + red[2] + red[3]) * (1.f / D);
    float q = 0.f;
    for (int i = 0; i < 4; ++i) { v[i] -= mean; q += v[i] * v[i]; }
    for (int o = 32; o > 0; o >>= 1) q += __shfl_xor(q, o);
    if ((t & 63) == 0) red[4 + (t >> 6)] = q;
    __syncthreads();
    const float var = (red[4] + red[5] + red[6] + red[7]) * (1.f / D);
    const float rstd = 1.0f / sqrtf(var + LN_EPS);
    for (int i = 0; i < 4; ++i) { const int c = t + 256 * i; out[(size_t)row * D + c] = v[i] * rstd * g[c] + b[c]; }
}

__global__ void k_rope_table(const int* __restrict__ pos, float* __restrict__ cs) {
    const int idx = blockIdx.x * blockDim.x + threadIdx.x;
    if (idx >= M * 8) return;
    const int tok = idx >> 3, i = idx & 7;
    const float inv = powf(500000.0f, -(float)i * 2.0f / 16.0f);
    const float ang = (float)pos[tok] * inv;
    cs[tok * 16 + i] = cosf(ang); cs[tok * 16 + 8 + i] = sinf(ang);
}
__global__ void k_rope_apply(float* __restrict__ U, int ld, int c0, int nh, const float* __restrict__ cs) {
    const int idx = blockIdx.x * blockDim.x + threadIdx.x;
    if (idx >= M * nh * 8) return;
    const int i = idx & 7, h = (idx >> 3) % nh, tok = idx / (8 * nh);
    float* p = U + (size_t)tok * ld + c0 + h * 64;
    const float c = cs[tok * 16 + i], s = cs[tok * 16 + 8 + i];
    const float x1 = p[i], x2 = p[8 + i];
    p[i] = x1 * c - x2 * s; p[8 + i] = x2 * c + x1 * s;
}
__global__ void k_pool_prep(const float* __restrict__ U, float* __restrict__ P) {
    const int idx = blockIdx.x * blockDim.x + threadIdx.x;
    if (idx >= M * 512) return;
    const int c = idx & 511, tok = idx >> 9, t = tok % S, g = c >> 7;
    const int w = 2 << g;
    const int lo = (t + 1 - w) > 0 ? (t + 1 - w) : 0;
    float tot = 0.f;
    for (int s = lo; s <= t; ++s) tot += U[(size_t)(tok - t + s) * EW + c];
    const float cnt = (float)((t + 1) < w ? (t + 1) : w);
    P[idx] = tot / cnt - U[(size_t)tok * EW + c];
}
__global__ void __launch_bounds__(64) k_compress(const float* __restrict__ U, int c0, const float* __restrict__ pe, const float* __restrict__ w, float* __restrict__ out, const int* __restrict__ pos, int do_rope) {
    __shared__ float xs[2048];
    __shared__ float res[64];
    const int g = blockIdx.x & 1, n = (blockIdx.x >> 1) % NC, b = blockIdx.x / (2 * NC);
    const int j = threadIdx.x;
    for (int i = j; i < 2048; i += 64) { const int l = i >> 6, d = i & 63; xs[i] = U[(size_t)(b * S + 16 * n + l) * EW + c0 + g * 64 + d] + pe[i]; }
    __syncthreads();
    float acc = 0.f;
    for (int i = 0; i < 2048; ++i) acc += xs[i] * w[(size_t)i * 64 + j];
    res[j] = acc;
    __syncthreads();
    float o = acc;
    if (do_rope && j < 16) {
        const int i = j & 7;
        const float inv = powf(500000.0f, -(float)i * 2.0f / 16.0f);
        const float ang = (float)pos[b * S + 16 * n + 31] * inv;
        const float c = cosf(ang), s = sinf(ang);
        o = (j < 8) ? (res[i] * c - res[8 + i] * s) : (res[8 + i] * c + res[i] * s);
    }
    out[(size_t)blockIdx.x * 64 + j] = o;
}

__global__ void __launch_bounds__(256) k_nsa(const float* __restrict__ U, const float* __restrict__ KC, const float* __restrict__ VC, float* __restrict__ CAT) {
    __shared__ float q[4][64];
    __shared__ float sc[4][1024];
    __shared__ float imp[128];
    __shared__ int sel[16];
    __shared__ float red[4][4];
    __shared__ float gate[4][3];
    const int g = blockIdx.x & 1, tok = blockIdx.x >> 1, b = tok / S, t = tok % S;
    const int tid = threadIdx.x, h = tid >> 6, d = tid & 63;
    const float scale = 0.125f;
    q[h][d] = U[(size_t)tok * EW + C_Q + (g * 4 + h) * 64 + d];
    if (tid < 12) { const int hh = tid / 3, br = tid % 3; const float z = U[(size_t)tok * EW + C_GATE + (g * 4 + hh) * 3 + br]; gate[hh][br] = 1.f / (1.f + expf(-z)); }
    __syncthreads();
    const int nvalid = (t >= 31) ? ((t - 31) / 16 + 1) : 0;
    for (int n = d; n < 512; n += 64) {
        float s = -1e30f;
        if (n < nvalid) { s = 0.f; const float* kp = KC + ((size_t)(b * NC + n) * 2 + g) * 64; for (int e = 0; e < 64; ++e) s += q[h][e] * kp[e]; s *= scale; }
        sc[h][n] = s;
    }
    __syncthreads();
    {
        float mx = -1e30f; for (int n = d; n < nvalid; n += 64) mx = fmaxf(mx, sc[h][n]);
        for (int o = 32; o > 0; o >>= 1) mx = fmaxf(mx, __shfl_xor(mx, o));
        float sm = 0.f; for (int n = d; n < nvalid; n += 64) sm += expf(sc[h][n] - mx);
        for (int o = 32; o > 0; o >>= 1) sm += __shfl_xor(sm, o);
        for (int n = d; n < 512; n += 64) sc[h][n] = (n < nvalid) ? expf(sc[h][n] - mx) / sm : 0.f;
    }
    __syncthreads();
    float o_c = 0.f;
    for (int n = 0; n < nvalid; ++n) o_c += sc[h][n] * VC[((size_t)(b * NC + n) * 2 + g) * 64 + d];
    const int cur = t >> 6;
    if (tid < 128) {
        const int j = tid; float v = 0.f;
        for (int n = 4 * j - 1; n <= 4 * j + 3; ++n) if (n >= 0 && n < NC) v += sc[0][n] + sc[1][n] + sc[2][n] + sc[3][n];
        const bool forced = (j == 0) || (j == cur) || (j == cur - 1);
        const bool future = j > cur;
        imp[j] = forced ? 1e4f : (future ? -1.f : v);
    }
    __syncthreads();
    if (tid < 128) {
        const int j = tid; const float v = imp[j]; int rank = 0;
        for (int k = 0; k < 128; ++k) { const float w = imp[k]; rank += (w > v || (w == v && k < j)) ? 1 : 0; }
        if (rank < 16) sel[rank] = j;
    }
    __syncthreads();
    for (int i = d; i < 1024; i += 64) {
        const int kpos = sel[i >> 6] * 64 + (i & 63);
        float s = -1e30f;
        if (kpos <= t) { s = 0.f; const float* kp = U + (size_t)(b * S + kpos) * EW + C_KS + g * 64; for (int e = 0; e < 64; ++e) s += q[h][e] * kp[e]; s *= scale; }
        sc[h][i] = s;
    }
    __syncthreads();
    float o_s = 0.f;
    {
        float mx = -1e30f; for (int i = d; i < 1024; i += 64) mx = fmaxf(mx, sc[h][i]);
        for (int o = 32; o > 0; o >>= 1) mx = fmaxf(mx, __shfl_xor(mx, o));
        float sm = 0.f; for (int i = d; i < 1024; i += 64) { const int kpos = sel[i >> 6] * 64 + (i & 63); if (kpos <= t) sm += expf(sc[h][i] - mx); }
        for (int o = 32; o > 0; o >>= 1) sm += __shfl_xor(sm, o);
        for (int i = d; i < 1024; i += 64) { const int kpos = sel[i >> 6] * 64 + (i & 63); sc[h][i] = (kpos <= t) ? expf(sc[h][i] - mx) / sm : 0.f; }
        __syncthreads();
        for (int i = 0; i < 1024; ++i) { const float p = sc[h][i]; if (p != 0.f) { const int kpos = sel[i >> 6] * 64 + (i & 63); o_s += p * U[(size_t)(b * S + kpos) * EW + C_VS + g * 64 + d]; } }
    }
    __syncthreads();
    const int k0 = (t - 511) > 0 ? (t - 511) : 0; const int nk = t - k0 + 1;
    for (int i = d; i < nk; i += 64) {
        float s = 0.f; const float* kp = U + (size_t)(b * S + k0 + i) * EW + C_KW + g * 64; for (int e = 0; e < 64; ++e) s += q[h][e] * kp[e];
        sc[h][i] = s * scale;
    }
    __syncthreads();
    float o_w = 0.f;
    {
        float mx = -1e30f; for (int i = d; i < nk; i += 64) mx = fmaxf(mx, sc[h][i]);
        for (int o = 32; o > 0; o >>= 1) mx = fmaxf(mx, __shfl_xor(mx, o));
        float sm = 0.f; for (int i = d; i < nk; i += 64) sm += expf(sc[h][i] - mx);
        for (int o = 32; o > 0; o >>= 1) sm += __shfl_xor(sm, o);
        for (int i = d; i < nk; i += 64) sc[h][i] = expf(sc[h][i] - mx) / sm;
        __syncthreads();
        for (int i = 0; i < nk; ++i) o_w += sc[h][i] * U[(size_t)(b * S + k0 + i) * EW + C_VW + g * 64 + d];
    }
    (void)red;
    CAT[(size_t)tok * D + 512 + (g * 4 + h) * 64 + d] = gate[h][0] * o_c + gate[h][1] * o_s + gate[h][2] * o_w;
}

__global__ void k_conv(const float* __restrict__ XR, const float* __restrict__ cw, const float* __restrict__ cb, float* __restrict__ XC) {
    const int idx = blockIdx.x * blockDim.x + threadIdx.x;
    if (idx >= M * 128) return;
    const int c = idx & 127, tok = idx >> 7, t = tok % S;
    float v = cb[c];
    for (int k = 0; k < 4; ++k) { const int tt = t - 3 + k; if (tt >= 0) v += XR[(size_t)(tok - 3 + k) * 128 + c] * cw[k * RNN + c]; }
    XC[idx] = v;
}
__global__ void k_ab(const float* __restrict__ RP, const float* __restrict__ IP, const float* __restrict__ XC, const float* __restrict__ ba, const float* __restrict__ bx,
                     const float* __restrict__ lam, const int* __restrict__ pos, float* __restrict__ Aout, float* __restrict__ Bout) {
    const int idx = blockIdx.x * blockDim.x + threadIdx.x;
    if (idx >= M * 128) return;
    const int c = idx & 127, tok = idx >> 7;
    const float r = 1.f / (1.f + expf(-(RP[idx] + ba[c])));
    const float i = 1.f / (1.f + expf(-(IP[idx] + bx[c])));
    const float nl = -lam[c];
    const float sp = (nl > 20.f) ? nl : log1pf(expf(nl));
    const float log_a = -8.0f * r * sp;
    float a = expf(log_a);
    float mult = sqrtf(-expm1f(2.0f * log_a));
    if (pos[tok] == 0) { a = 0.f; mult = 1.f; }
    Aout[idx] = a; Bout[idx] = mult * (i * XC[idx]);
}
__device__ __forceinline__ float gelu_tanh(float x) { const float u = 0.7978845608028654f * (x + 0.044715f * x * x * x); return 0.5f * x * (1.f + tanhf(u)); }
__global__ void k_scan(const float* __restrict__ Ain, const float* __restrict__ Bin, const float* __restrict__ G, float* __restrict__ Y) {
    const int idx = blockIdx.x * blockDim.x + threadIdx.x;
    if (idx >= B * 128) return;
    const int c = idx & 127, b = idx >> 7;
    float h = 0.f;
    for (int t = 0; t < S; ++t) {
        const size_t o = (size_t)(b * S + t) * 128 + c;
        h = Ain[o] * h + Bin[o];
        Y[(size_t)(b * S + t) * RNN + c] = h * gelu_tanh(G[o]);
    }
}
__global__ void __launch_bounds__(256) k_xattn(const float* __restrict__ Q, const float* __restrict__ KV, float* __restrict__ O) {
    __shared__ float q[1024];
    __shared__ float p[4][256];
    const int tok = blockIdx.x, b = tok / S, tid = threadIdx.x;
    for (int i = tid; i < 1024; i += 256) q[i] = Q[(size_t)tok * D + i];
    __syncthreads();
    for (int h = 0; h < 4; ++h) {
        const float* kp = KV + (size_t)(b * NMEM + tid) * 2048 + h * 256;
        float s = 0.f; for (int e = 0; e < 256; ++e) s += q[h * 256 + e] * kp[e];
        p[h][tid] = s * 0.0625f;
    }
    __syncthreads();
    {
        const int h = tid >> 6, l = tid & 63;
        float mx = -1e30f; for (int i = l; i < 256; i += 64) mx = fmaxf(mx, p[h][i]);
        for (int o = 32; o > 0; o >>= 1) mx = fmaxf(mx, __shfl_xor(mx, o));
        float sm = 0.f; for (int i = l; i < 256; i += 64) sm += expf(p[h][i] - mx);
        for (int o = 32; o > 0; o >>= 1) sm += __shfl_xor(sm, o);
        for (int i = l; i < 256; i += 64) p[h][i] = expf(p[h][i] - mx) / sm;
    }
    __syncthreads();
    for (int h = 0; h < 4; ++h) {
        float o = 0.f;
        for (int m = 0; m < 256; ++m) o += p[h][m] * KV[(size_t)(b * NMEM + m) * 2048 + 1024 + h * 256 + tid];
        O[(size_t)tok * D + h * 256 + tid] = o;
    }
}
__global__ void k_swiglu(const float* __restrict__ Hup, float* __restrict__ Hact, int rows) {
    const size_t idx = (size_t)blockIdx.x * blockDim.x + threadIdx.x;
    if (idx >= (size_t)rows * FF) return;
    const size_t tok = idx / FF; const int c = (int)(idx % FF);
    const float a = Hup[tok * 5632 + c], u = Hup[tok * 5632 + FF + c];
    Hact[idx] = a / (1.f + expf(-a)) * u;
}
}

static void gemm(hipStream_t st, const float* A, int lda, const float* W, int ldw, float* C, int ldc, int Mr, int N, int K, const float* cs = nullptr) {
    dim3 grid((N + 63) / 64, (Mr + 63) / 64);
    nv::k_gemm<<<grid, 256, 0, st>>>(A, lda, W, ldw, C, ldc, Mr, N, K, cs);
}

extern "C" void kernel_launch(void* const* d_in, const int* in_sizes, int n_in, void* d_out, int out_size, void* d_ws, size_t ws_size, hipStream_t stream) {
    using namespace nv;
    const float* x = (const float*)d_in[0]; const float* mem = (const float*)d_in[1]; const int* pos = (const int*)d_in[2];
    const float* e_w_in = (const float*)d_in[3]; const float* e_pool_w = (const float*)d_in[4]; const float* e_pool_scale = (const float*)d_in[5];
    const float* e_pk = (const float*)d_in[6]; const float* e_pv = (const float*)d_in[7]; const float* e_wk = (const float*)d_in[8]; const float* e_wv = (const float*)d_in[9];
    const float* e_w_out = (const float*)d_in[10]; const float* o_w_in = (const float*)d_in[11]; const float* o_conv_w = (const float*)d_in[12]; const float* o_conv_b = (const float*)d_in[13];
    const float* o_wa = (const float*)d_in[14]; const float* o_ba = (const float*)d_in[15]; const float* o_wx = (const float*)d_in[16]; const float* o_bx = (const float*)d_in[17];
    const float* o_lam = (const float*)d_in[18]; const float* o_w_out = (const float*)d_in[19]; const float* x_wq = (const float*)d_in[20]; const float* x_wkv = (const float*)d_in[21];
    const float* x_wo = (const float*)d_in[22]; const float* f_up = (const float*)d_in[23]; const float* f_down = (const float*)d_in[24]; const float* ln_g = (const float*)d_in[25]; const float* ln_b = (const float*)d_in[26];
    float* out = (float*)d_out;
    if (ws_size < ((size_t)256 << 20)) { fprintf(stderr, "ws too small: %zu\n", ws_size); return; }
    char* wsb = (char*)d_ws;
    auto R = [&](size_t mib) { return (float*)(wsb + (mib << 20)); };
    float* T0 = out;
    const int CH = 1024;
    auto ffn = [&](const float* XBp, int layer, float* UP, float* ACT) {
        for (int r0 = 0; r0 < M; r0 += CH) {
            gemm(stream, XBp + (size_t)r0 * D, D, f_up + (size_t)layer * D * 5632, 5632, UP, 5632, CH, 5632, D);
            k_swiglu<<<(unsigned)(((size_t)CH * FF + 255) / 256), 256, 0, stream>>>(UP, ACT, CH);
            gemm(stream, ACT, FF, f_down + (size_t)layer * FF * D, D, T0 + (size_t)r0 * D, D, CH, D, FF);
        }
    };
    auto lng = [&](int layer, int i) { return ln_g + (size_t)(layer * 3 + i) * D; };
    auto lnb = [&](int layer, int i) { return ln_b + (size_t)(layer * 3 + i) * D; };
    {
        float* U = R(0); float* CAT = R(128); float* PL = R(192); float* KC = R(224); float* VC = R(225); float* CS = R(226); float* KV = R(228);
        gemm(stream, x, D, e_w_in, EW, U, EW, M, EW, D);
        k_rope_table<<<(M * 8 + 255) / 256, 256, 0, stream>>>(pos, CS);
        k_pool_prep<<<(M * 512 + 255) / 256, 256, 0, stream>>>(U, PL);
        for (int g = 0; g < 4; ++g) gemm(stream, PL + g * 128, 512, e_pool_w + (size_t)g * 128 * 128, 128, CAT + g * 128, D, M, 128, 128, e_pool_scale + g * 128);
        k_compress<<<B * NC * 2, 64, 0, stream>>>(U, C_KC, e_pk, e_wk, KC, pos, 1);
        k_compress<<<B * NC * 2, 64, 0, stream>>>(U, C_VC, e_pv, e_wv, VC, pos, 0);
        k_rope_apply<<<(M * 8 * 8 + 255) / 256, 256, 0, stream>>>(U, EW, C_Q, 8, CS);
        k_rope_apply<<<(M * 2 * 8 + 255) / 256, 256, 0, stream>>>(U, EW, C_KS, 2, CS);
        k_rope_apply<<<(M * 2 * 8 + 255) / 256, 256, 0, stream>>>(U, EW, C_KW, 2, CS);
        k_nsa<<<M * 2, 256, 0, stream>>>(U, KC, VC, CAT);
        gemm(stream, CAT, D, e_w_out, D, T0, D, M, D, D);
        float* XA = R(0); float* QB = R(64); float* XB = R(64);
        k_ln<<<M, 256, 0, stream>>>(x, T0, lng(0, 0), lnb(0, 0), XA);
        gemm(stream, XA, D, x_wq, D, QB, D, M, D, D);
        gemm(stream, mem, D, x_wkv, 2048, KV, 2048, B * NMEM, 2048, D);
        k_xattn<<<M, 256, 0, stream>>>(QB, KV, CAT);
        gemm(stream, CAT, D, x_wo, D, T0, D, M, D, D);
        k_ln<<<M, 256, 0, stream>>>(XA, T0, lng(0, 1), lnb(0, 1), XB);
        ffn(XB, 0, R(192), R(232));
        k_ln<<<M, 256, 0, stream>>>(XB, T0, lng(0, 2), lnb(0, 2), R(0));
    }
    {
        const float* xin = R(0); float* Y = R(64);
        float* Gh = R(144); float* XR = R(152); float* XC = R(160); float* RP = R(168); float* IP = R(176); float* AA = R(184); float* BB = R(192);
        for (int h = 0; h < 10; ++h) {
            gemm(stream, xin, D, o_w_in + h * 128, 2560, Gh, 128, M, 128, D);
            gemm(stream, xin, D, o_w_in + RNN + h * 128, 2560, XR, 128, M, 128, D);
            k_conv<<<(M * 128 + 255) / 256, 256, 0, stream>>>(XR, o_conv_w + h * 128, o_conv_b + h * 128, XC);
            gemm(stream, XC, 128, o_wa + (size_t)h * 128 * 128, 128, RP, 128, M, 128, 128);
            gemm(stream, XC, 128, o_wx + (size_t)h * 128 * 128, 128, IP, 128, M, 128, 128);
            k_ab<<<(M * 128 + 255) / 256, 256, 0, stream>>>(RP, IP, XC, o_ba + h * 128, o_bx + h * 128, o_lam + h * 128, pos, AA, BB);
            k_scan<<<(B * 128 + 63) / 64, 64, 0, stream>>>(AA, BB, Gh, Y + h * 128);
        }
        gemm(stream, Y, RNN, o_w_out, D, T0, D, M, D, RNN);
        float* XA = R(192); float* QB = R(0); float* KV = R(128); float* CAT = R(64); float* XB = R(0);
        k_ln<<<M, 256, 0, stream>>>(xin, T0, lng(1, 0), lnb(1, 0), XA);
        gemm(stream, XA, D, x_wq + (size_t)D * D, D, QB, D, M, D, D);
        gemm(stream, mem, D, x_wkv + (size_t)D * 2048, 2048, KV, 2048, B * NMEM, 2048, D);
        k_xattn<<<M, 256, 0, stream>>>(QB, KV, CAT);
        gemm(stream, CAT, D, x_wo + (size_t)D * D, D, T0, D, M, D, D);
        k_ln<<<M, 256, 0, stream>>>(XA, T0, lng(1, 1), lnb(1, 1), XB);
        ffn(XB, 1, R(128), R(152));
        k_ln<<<M, 256, 0, stream>>>(XB, T0, lng(1, 2), lnb(1, 2), out);
    }
}
```
